# Optimizing an MI355X kernel written in HIP

```python
import jax, jax.numpy as jnp
from jax import lax
import numpy as np

D_MODEL = 1024
BATCH = 4
SEQ = 8192
DEPTH = 2

N_MIXERS = 2
D_FF = 2816
CONV_WIDTH = 3
MLSTM_HEADS = 4
MLSTM_QK_DIM = D_MODEL // 2 // MLSTM_HEADS
MLSTM_V_DIM = D_MODEL // MLSTM_HEADS
MLSTM_CHUNK = 64
MLSTM_IN_DIM = 2 * MLSTM_HEADS * MLSTM_QK_DIM + 2 * MLSTM_HEADS * MLSTM_V_DIM + 2 * MLSTM_HEADS
NORM_EPS = 1e-6

kernel_name = "hybrid_shortconv_mlstm_macaron"


def rms_norm(x, g):
    xf = x.astype(jnp.float32)
    y = xf * lax.rsqrt(jnp.mean(xf * xf, axis=-1, keepdims=True) + NORM_EPS)
    return (y * g.astype(jnp.float32)).astype(x.dtype)


def swiglu(x, w_gate, w_up, w_down):
    return (jax.nn.silu(x @ w_gate) * (x @ w_up)) @ w_down


def short_conv_mixer(x, w_in, conv_w, w_out):
    S = x.shape[1]
    gate_b, gate_c, h = jnp.split(x @ w_in, 3, axis=-1)
    u = gate_c * h
    up = jnp.pad(u, ((0, 0), (CONV_WIDTH - 1, 0), (0, 0)))
    conv = conv_w[0] * up[:, 0:S]
    for k in range(1, CONV_WIDTH):
        conv = conv + conv_w[k] * up[:, k:k + S]
    return (gate_b * conv) @ w_out


def mlstm_chunkwise(q, k, v, log_i, log_f):
    B, H, S, DQK = q.shape
    DV = v.shape[-1]
    L = MLSTM_CHUNK
    NC = S // L

    def to_chunks(t):
        return jnp.moveaxis(t.reshape(B, H, NC, L, *t.shape[3:]), 2, 0)

    causal = jnp.tril(jnp.ones((L, L), dtype=bool))

    def step(carry, inp):
        C, n, m = carry
        qj, kj, vj, ij, fj = inp
        bcum = jnp.cumsum(fj, axis=-1)
        log_d = bcum[..., :, None] - bcum[..., None, :] + ij[..., None, :]
        log_d = jnp.where(causal, log_d, -jnp.inf)
        log_inter = bcum + m[..., None]
        m_row = jnp.maximum(log_inter, jnp.max(log_d, axis=-1))
        w_intra = jnp.exp(log_d - m_row[..., None])
        w_inter = jnp.exp(log_inter - m_row)
        s = jnp.einsum('bhld,bhsd->bhls', qj, kj) * w_intra
        num = (jnp.einsum('bhls,bhsv->bhlv', s, vj)
               + w_inter[..., None] * jnp.einsum('bhld,bhdv->bhlv', qj, C))
        den = jnp.sum(s, axis=-1) + w_inter * jnp.einsum('bhld,bhd->bhl', qj, n)
        h = num / jnp.maximum(jnp.abs(den), jnp.exp(-m_row))[..., None]
        b_last = bcum[..., -1]
        log_w = b_last[..., None] - bcum + ij
        m_new = jnp.maximum(b_last + m, jnp.max(log_w, axis=-1))
        w_state = jnp.exp(log_w - m_new[..., None])
        decay = jnp.exp(b_last + m - m_new)
        C_new = decay[..., None, None] * C + jnp.einsum('bhs,bhsd,bhsv->bhdv', w_state, kj, vj)
        n_new = decay[..., None] * n + jnp.einsum('bhs,bhsd->bhd', w_state, kj)
        return (C_new, n_new, m_new), h

    init = (jnp.zeros((B, H, DQK, DV), jnp.float32),
            jnp.zeros((B, H, DQK), jnp.float32),
            jnp.zeros((B, H), jnp.float32))
    _, hc = lax.scan(step, init, tuple(to_chunks(t) for t in (q, k, v, log_i, log_f)))
    return jnp.moveaxis(hc, 0, 2).reshape(B, H, S, DV)


def mlstm_mixer(x, w_in, b_gates, head_norm, w_out):
    B, S, _ = x.shape
    NH, DQK, DV = MLSTM_HEADS, MLSTM_QK_DIM, MLSTM_V_DIM
    splits = [NH * DQK, 2 * NH * DQK, 2 * NH * DQK + NH * DV, 2 * NH * DQK + 2 * NH * DV]
    q, k, v, o, g = jnp.split(x @ w_in, splits, axis=-1)

    def heads(t, d):
        return t.reshape(B, S, NH, d).transpose(0, 2, 1, 3).astype(jnp.float32)

    q = heads(q, DQK)
    k = heads(k, DQK) * (DQK ** -0.5)
    v = heads(v, DV)
    g = (g.astype(jnp.float32) + b_gates.astype(jnp.float32)).transpose(0, 2, 1)
    log_i = g[:, :NH]
    log_f = jax.nn.log_sigmoid(g[:, NH:])
    h = mlstm_chunkwise(q, k, v, log_i, log_f)
    h = h * lax.rsqrt(jnp.mean(h * h, axis=-1, keepdims=True) + NORM_EPS)
    h = h * head_norm.astype(jnp.float32)[None, :, None, :]
    h = h.transpose(0, 2, 1, 3).reshape(B, S, NH * DV).astype(x.dtype)
    return (h * jax.nn.sigmoid(o)) @ w_out


def setup_inputs(seed: int = 0) -> dict:
    key = jax.random.key(seed)
    ks = jax.random.split(key, 20)
    D, F = D_MODEL, D_FF
    n_conv = (DEPTH + 1) // 2
    n_ml = DEPTH // 2
    nrm = lambda k, shape, scale: jax.random.normal(k, shape, jnp.float32) * scale
    forget_bias = jnp.linspace(3.0, 6.0, MLSTM_HEADS, dtype=jnp.float32)
    b_gates = jnp.concatenate([
        nrm(ks[10], (n_ml, MLSTM_HEADS), 0.1),
        forget_bias[None, :] + nrm(ks[11], (n_ml, MLSTM_HEADS), 0.1)], axis=-1)
    return {
        "x": nrm(ks[0], (BATCH, SEQ, D), 1.0),
        "norm_g": 1.0 + nrm(ks[1], (DEPTH, 3, D), 0.02),
        "ffn_w_gate": nrm(ks[2], (DEPTH, 2, D, F), D ** -0.5),
        "ffn_w_up": nrm(ks[3], (DEPTH, 2, D, F), D ** -0.5),
        "ffn_w_down": nrm(ks[4], (DEPTH, 2, F, D), F ** -0.5),
        "conv_w_in": nrm(ks[5], (n_conv, D, 3 * D), D ** -0.5),
        "conv_w": nrm(ks[6], (n_conv, CONV_WIDTH, D), CONV_WIDTH ** -0.5),
        "conv_w_out": nrm(ks[7], (n_conv, D, D), D ** -0.5),
        "mlstm_w_in": nrm(ks[8], (n_ml, D, MLSTM_IN_DIM), D ** -0.5),
        "mlstm_b_gates": b_gates,
        "mlstm_head_norm": 1.0 + nrm(ks[12], (n_ml, MLSTM_HEADS, MLSTM_V_DIM), 0.02),
        "mlstm_w_out": nrm(ks[9], (n_ml, D, D), D ** -0.5),
        "final_norm_g": 1.0 + nrm(ks[13], (D,), 0.02),
    }


def reference(x, norm_g, ffn_w_gate, ffn_w_up, ffn_w_down, conv_w_in, conv_w, conv_w_out,
              mlstm_w_in, mlstm_b_gates, mlstm_head_norm, mlstm_w_out, final_norm_g):
    h = x
    for layer in range(DEPTH):
        h = h + 0.5 * swiglu(rms_norm(h, norm_g[layer, 0]),
                             ffn_w_gate[layer, 0], ffn_w_up[layer, 0], ffn_w_down[layer, 0])
        hn = rms_norm(h, norm_g[layer, 1])
        j = layer // N_MIXERS
        if layer % N_MIXERS == 0:
            mix = short_conv_mixer(hn, conv_w_in[j], conv_w[j], conv_w_out[j])
        else:
            mix = mlstm_mixer(hn, mlstm_w_in[j], mlstm_b_gates[j], mlstm_head_norm[j], mlstm_w_out[j])
        h = h + mix
        h = h + 0.5 * swiglu(rms_norm(h, norm_g[layer, 2]),
                             ffn_w_gate[layer, 1], ffn_w_up[layer, 1], ffn_w_down[layer, 1])
    return rms_norm(h, final_norm_g)
```

```cpp
#include <hip/hip_runtime.h>
#include <cstdio>
#include <cstdint>

#ifndef MK_N_LAUNCHES
#define MK_N_LAUNCHES 18
#endif

namespace pg8 {
#define PG8_LAS __attribute__((address_space(3)))
typedef unsigned short bf16_t;
typedef short bf16x8 __attribute__((ext_vector_type(8)));
typedef float f32x4 __attribute__((ext_vector_type(4)));
typedef unsigned u32x4 __attribute__((ext_vector_type(4)));
constexpr int BM = 256, BK = 64, HALF = 128, HTB = HALF * BK * 2  , STAGE_BYTES = 8 * HTB, NXCD = 8, WGM = 8;

__host__ __device__ __forceinline__ int lds_byte(int r, int c) { const int st = (r >> 4) * 2 + (c >> 5), rr = r & 15, cc = c & 31, ob = rr * 64 + cc * 2; return st * 1024 + (ob ^ (((ob >> 9) & 1) << 5)); }
__host__ __device__ __forceinline__ void stage_rc(int b, int& R, int& C) { const int st = b / 1024, sb = b % 1024, swz = sb ^ (((sb >> 9) & 1) << 5); R = (st >> 1) * 16 + swz / 64; C = (st & 1) * 32 + (swz % 64) / 2; }
__host__ __device__ __forceinline__ int perm32(int rho) { const int n = rho >> 4, i = rho & 15; return 8 * (i >> 2) + 4 * n + (i & 3); }

struct Unit { int pm, pn; };
struct Gemm { const bf16_t* A; const bf16_t* Bt; int M, N, K; };

struct StaticOrder {
    int nM, nN, nwg, G, c;
    __host__ __device__ void init(int M, int N, int G_, int c_) { nM = M / BM; nN = N / BM; nwg = nM * nN; G = G_; c = c_; }
    __host__ __device__ bool next(int i, Unit& u) const {
        const long L = (long)i * G + c; if (L >= nwg) return false;
        int wgid = (int)L; { const int q = nwg / NXCD, r = nwg % NXCD, xcd = wgid % NXCD, off = wgid / NXCD; wgid = (xcd < r ? xcd * (q + 1) : r * (q + 1) + (xcd - r) * q) + off; }
        const int nig = WGM * nN, gid = wgid / nig, fm = gid * WGM, gsz = (nM - fm) < WGM ? (nM - fm) : WGM;
        u.pm = fm + ((wgid % nig) % gsz); u.pn = (wgid % nig) / gsz; return true;
    }
    __device__ __forceinline__ void a_ready(const Unit&) const {}
    __device__ __forceinline__ void done(const Unit&) const {}
};

__device__ __forceinline__ unsigned cvt_pk_bf16(float lo, float hi) { unsigned r; asm volatile("v_cvt_pk_bf16_f32 %0, %1, %2" : "=v"(r) : "v"(lo), "v"(hi)); return r; }

struct RstdTab {
    int p0, p1, p2, p3; const PG8_LAS float* tab;
    __device__ __forceinline__ const PG8_LAS float* panel(int pm) const { const int s = (pm == p0) ? 0 : (pm == p1) ? 1 : (pm == p2) ? 2 : 3; return tab + s * 256; }
};

__device__ __forceinline__ float silu_f(float x) { return x * __builtin_amdgcn_rcpf(1.0f + __builtin_amdgcn_exp2f(-1.44269504089f * x)); }

struct EpiGU {
    static constexpr bool PERM = true, AFTER_DRAIN = false;
    bf16_t* O; int ldc; RstdTab rt;
    __device__ __forceinline__ void operator()(const f32x4 (&acc)[2][2][4][2], const Unit& u, int wr, int wc, int fr, int fq) const {
        const PG8_LAS float* rp = rt.panel(u.pm);
        const int col0 = u.pn * 128 + wc * 32 + 8 * fq;
#pragma unroll
        for (int ai = 0; ai < 2; ++ai)
#pragma unroll
            for (int m = 0; m < 4; ++m) {
                const int rl = ai * HALF + wr * 64 + m * 16 + fr; const float rs = rp[rl];
                const f32x4 g0 = acc[ai][0][m][0] * rs, g1 = acc[ai][0][m][1] * rs, u0 = acc[ai][1][m][0] * rs, u1 = acc[ai][1][m][1] * rs;
                float o[8];
#pragma unroll
                for (int j = 0; j < 4; ++j) { o[j] = silu_f(g0[j]) * u0[j]; o[4 + j] = silu_f(g1[j]) * u1[j]; }
                u32x4 w; w.x = cvt_pk_bf16(o[0], o[1]); w.y = cvt_pk_bf16(o[2], o[3]); w.z = cvt_pk_bf16(o[4], o[5]); w.w = cvt_pk_bf16(o[6], o[7]);
                *(u32x4*)(O + (size_t)(u.pm * BM + rl) * ldc + col0) = w;
            }
    }
};
struct EpiRes {
    static constexpr bool PERM = true, AFTER_DRAIN = false;
    const float* base; float* out; bf16_t* hb; float* ssq; float scale;
    __device__ __forceinline__ void operator()(const f32x4 (&acc)[2][2][4][2], const Unit& u, int wr, int wc, int fr, int fq) const {
        const int col0 = u.pn * BM + wc * 32 + 8 * fq;
#pragma unroll
        for (int ai = 0; ai < 2; ++ai)
#pragma unroll
            for (int m = 0; m < 4; ++m) {
                const int row = u.pm * BM + ai * HALF + wr * 64 + m * 16 + fr; const size_t off = (size_t)row * 1024 + col0; float s = 0.f;
#pragma unroll
                for (int bj = 0; bj < 2; ++bj) {
                    const f32x4 b0 = *(const f32x4*)(base + off + bj * HALF), b1 = *(const f32x4*)(base + off + bj * HALF + 4);
                    const f32x4 o0 = b0 + acc[ai][bj][m][0] * scale, o1 = b1 + acc[ai][bj][m][1] * scale;
                    *(f32x4*)(out + off + bj * HALF) = o0; *(f32x4*)(out + off + bj * HALF + 4) = o1;
                    u32x4 w; w.x = cvt_pk_bf16(o0[0], o0[1]); w.y = cvt_pk_bf16(o0[2], o0[3]); w.z = cvt_pk_bf16(o1[0], o1[1]); w.w = cvt_pk_bf16(o1[2], o1[3]);
                    *(u32x4*)(hb + off + bj * HALF) = w;
                    s += (o0[0] * o0[0] + o0[1] * o0[1]) + (o0[2] * o0[2] + o0[3] * o0[3]) + (o1[0] * o1[0] + o1[1] * o1[1]) + (o1[2] * o1[2] + o1[3] * o1[3]);
                }
                s += __shfl_xor(s, 16); s += __shfl_xor(s, 32);
                if (fq == 0) ssq[(size_t)row * 16 + u.pn * 4 + wc] = s;
                asm volatile("" ::: "memory");
            }
    }
};
struct EpiConvIn {
    static constexpr bool PERM = true, AFTER_DRAIN = false;
    bf16_t* U; bf16_t* GBt; RstdTab rt;
    __device__ __forceinline__ void operator()(const f32x4 (&acc)[2][2][4][2], const Unit& u, int wr, int wc, int fr, int fq) const {
        const PG8_LAS float* rp = rt.panel(u.pm);
#pragma unroll
        for (int ai = 0; ai < 2; ++ai)
#pragma unroll
            for (int m = 0; m < 4; ++m) {
                const int rl = ai * HALF + wr * 64 + m * 16 + fr; const float rs = rp[rl]; const size_t rowo = (size_t)(u.pm * BM + rl) * 1024;
                if (u.pn < 8) {
                    const f32x4 c0 = acc[ai][0][m][0] * rs, c1 = acc[ai][0][m][1] * rs, h0 = acc[ai][1][m][0] * rs, h1 = acc[ai][1][m][1] * rs;
                    const f32x4 o0 = c0 * h0, o1 = c1 * h1;
                    u32x4 w; w.x = cvt_pk_bf16(o0[0], o0[1]); w.y = cvt_pk_bf16(o0[2], o0[3]); w.z = cvt_pk_bf16(o1[0], o1[1]); w.w = cvt_pk_bf16(o1[2], o1[3]);
                    *(u32x4*)(U + rowo + u.pn * 128 + wc * 32 + 8 * fq) = w;
                } else {
#pragma unroll
                    for (int bj = 0; bj < 2; ++bj) {
                        const f32x4 o0 = acc[ai][bj][m][0] * rs, o1 = acc[ai][bj][m][1] * rs;
                        u32x4 w; w.x = cvt_pk_bf16(o0[0], o0[1]); w.y = cvt_pk_bf16(o0[2], o0[3]); w.z = cvt_pk_bf16(o1[0], o1[1]); w.w = cvt_pk_bf16(o1[2], o1[3]);
                        *(u32x4*)(GBt + rowo + (u.pn - 8) * 256 + bj * HALF + wc * 32 + 8 * fq) = w;
                    }
                }
            }
    }
};
struct EpiPlain {
    static constexpr bool PERM = true, AFTER_DRAIN = false;
    bf16_t* O; int ldc; RstdTab rt;
    __device__ __forceinline__ void operator()(const f32x4 (&acc)[2][2][4][2], const Unit& u, int wr, int wc, int fr, int fq) const {
        const PG8_LAS float* rp = rt.panel(u.pm);
        const int col0 = u.pn * BM + wc * 32 + 8 * fq;
#pragma unroll
        for (int ai = 0; ai < 2; ++ai)
#pragma unroll
            for (int m = 0; m < 4; ++m) {
                const int rl = ai * HALF + wr * 64 + m * 16 + fr; const float rs = rp[rl]; bf16_t* rowp = O + (size_t)(u.pm * BM + rl) * ldc + col0;
#pragma unroll
                for (int bj = 0; bj < 2; ++bj) {
                    const f32x4 o0 = acc[ai][bj][m][0] * rs, o1 = acc[ai][bj][m][1] * rs;
                    u32x4 w; w.x = cvt_pk_bf16(o0[0], o0[1]); w.y = cvt_pk_bf16(o0[2], o0[3]); w.z = cvt_pk_bf16(o1[0], o1[1]); w.w = cvt_pk_bf16(o1[2], o1[3]);
                    *(u32x4*)(rowp + bj * HALF) = w;
                }
            }
    }
};

template <class Epi, class Sched, bool ALIGN_EPI = false, bool SP2 = false>
__device__ __forceinline__ void gemm_phase(PG8_LAS unsigned char* lds, const Gemm g, const Sched& S, const Epi& E) {
    const int tid = threadIdx.x, wid = __builtin_amdgcn_readfirstlane(tid >> 6), lane = tid & 63, wr = wid >> 2, wc = wid & 3, fr = lane & 15, fq = lane >> 4;
    const int K = g.K, nt = K / BK;
    unsigned voffA[2], voffB[2];
#pragma unroll
    for (int i = 0; i < 2; ++i) { int R, C; stage_rc(tid * 16 + i * 8192, R, C); const int Rb = Epi::PERM ? ((R & ~31) + perm32(R & 31)) : R;
        voffA[i] = (unsigned)(R * K + C) * 2u; voffB[i] = (unsigned)(Rb * K + C) * 2u; }
    const size_t kstep = (size_t)(BK * 2);
    const size_t hstep = (size_t)HALF * K * 2;
    const size_t tstep = 2 * hstep;
    const unsigned ldsw = (unsigned)wid * 1024u;
    const int aoff = lds_byte(wr * 64 + fr, fq * 8), boff = lds_byte(wc * 32 + fr, fq * 8);
#define PG8_SA(b, h) (((b) * 2 + (h)) * HTB)
#define PG8_SB(b, h) ((4 + (b) * 2 + (h)) * HTB)
#define PG8_STAGE(bufoff, gbase, voff) do { _Pragma("unroll") for (int _i = 0; _i < 2; ++_i) \
        __builtin_amdgcn_global_load_lds((const unsigned*)((const char*)(gbase) + (voff)[_i]), (PG8_LAS unsigned*)(lds + (bufoff) + ldsw + _i * 8192), 16, 0, 0); } while (0)
#define PG8_LDA(dst, b, h) do { _Pragma("unroll") for (int m = 0; m < 4; ++m) _Pragma("unroll") for (int k = 0; k < 2; ++k) dst[m][k] = *(const PG8_LAS bf16x8*)(lds + PG8_SA(b, h) + aoff + m * 2048 + k * 1024); } while (0)
#define PG8_LDB(dst, b, h) do { _Pragma("unroll") for (int n = 0; n < 2; ++n) _Pragma("unroll") for (int k = 0; k < 2; ++k) dst[n][k] = *(const PG8_LAS bf16x8*)(lds + PG8_SB(b, h) + boff + n * 2048 + k * 1024); } while (0)
#define PG8_MMA(ai, bj, At, Bt) do { __builtin_amdgcn_s_setprio(1); _Pragma("unroll") for (int m = 0; m < 4; ++m) _Pragma("unroll") for (int n = 0; n < 2; ++n) _Pragma("unroll") for (int k = 0; k < 2; ++k) \
        acc[ai][bj][m][n] = __builtin_amdgcn_mfma_f32_16x16x32_bf16(Bt[n][k], At[m][k], acc[ai][bj][m][n], 0, 0, 0); __builtin_amdgcn_s_setprio(0); } while (0)
#define PG8_WAIT_V(n) asm volatile("s_waitcnt vmcnt(" #n ")" ::: "memory")
#define PG8_WAIT_L(n) asm volatile("s_waitcnt lgkmcnt(" #n ")" ::: "memory")
#define PG8_BAR __builtin_amdgcn_s_barrier()
#define PG8_SCHED __builtin_amdgcn_sched_barrier(0)
    Unit cur, nxt; int ui = 0;
    if (!S.next(0, cur)) return;
    f32x4 acc[2][2][4][2];
#pragma unroll
    for (int a = 0; a < 2; ++a)
#pragma unroll
        for (int b = 0; b < 2; ++b)
#pragma unroll
            for (int m = 0; m < 4; ++m)
#pragma unroll
                for (int n = 0; n < 2; ++n) acc[a][b][m][n] = (f32x4){0.f, 0.f, 0.f, 0.f};
    bf16x8 At[4][2], B0[2][2], B1[2][2];
    const char* cA = (const char*)g.A + (size_t)cur.pm * tstep; const char* cB = (const char*)g.Bt + (size_t)cur.pn * tstep;
    S.a_ready(cur);
    if constexpr (SP2) {
        PG8_STAGE(PG8_SB(0, 0), cB, voffB); PG8_STAGE(PG8_SB(0, 1), cB + hstep, voffB); PG8_STAGE(PG8_SA(0, 0), cA, voffA); PG8_STAGE(PG8_SA(0, 1), cA + hstep, voffA);
        if (wr == 1) PG8_BAR;
        PG8_WAIT_V(2); PG8_BAR;
        PG8_STAGE(PG8_SB(1, 0), cB + kstep, voffB); PG8_STAGE(PG8_SA(1, 0), cA + kstep, voffA); PG8_STAGE(PG8_SB(1, 1), cB + hstep + kstep, voffB);
        PG8_WAIT_V(6); PG8_BAR;
    } else {
        PG8_STAGE(PG8_SB(0, 0), cB, voffB); PG8_STAGE(PG8_SA(0, 0), cA, voffA); PG8_STAGE(PG8_SB(0, 1), cB + hstep, voffB); PG8_STAGE(PG8_SA(0, 1), cA + hstep, voffA);
        if (wr == 1) PG8_BAR;
        PG8_WAIT_V(4); PG8_BAR;
        PG8_STAGE(PG8_SB(1, 0), cB + kstep, voffB); PG8_STAGE(PG8_SA(1, 0), cA + kstep, voffA); PG8_STAGE(PG8_SB(1, 1), cB + hstep + kstep, voffB);
        PG8_WAIT_V(6); PG8_BAR;
    }
    for (;;) {
        const bool has_next = S.next(ui + 1, nxt);
        const char* nA = has_next ? (const char*)g.A + (size_t)nxt.pm * tstep : cA; const char* nB = has_next ? (const char*)g.Bt + (size_t)nxt.pn * tstep : cB;
        for (int t = 0; t < nt; t += 2) {
            const bool last = (t == nt - 2);
            const char* a1 = cA + (size_t)(t + 1) * kstep;
            const char* a2 = last ? nA : cA + (size_t)(t + 2) * kstep; const char* b2 = last ? nB : cB + (size_t)(t + 2) * kstep;
            const char* a3 = a2 + kstep; const char* b3 = b2 + kstep;
            if (last && has_next) S.a_ready(nxt);
            if constexpr (SP2) {
            PG8_LDB(B0, 0, 0); PG8_LDB(B1, 0, 1); PG8_SCHED; PG8_LDA(At, 0, 0); PG8_STAGE(PG8_SA(1, 1), a1 + hstep, voffA);
            PG8_WAIT_V(8); PG8_WAIT_L(0); PG8_BAR; PG8_MMA(0, 0, At, B0); PG8_MMA(0, 1, At, B1); PG8_BAR; PG8_SCHED;
            PG8_LDA(At, 0, 1); PG8_STAGE(PG8_SB(0, 0), b2, voffB); PG8_STAGE(PG8_SB(0, 1), b2 + hstep, voffB); PG8_STAGE(PG8_SA(0, 0), a2, voffA);
            PG8_WAIT_V(8); PG8_WAIT_L(0); PG8_BAR; PG8_MMA(1, 0, At, B0); PG8_MMA(1, 1, At, B1); PG8_BAR; PG8_SCHED;
            PG8_LDB(B0, 1, 0); PG8_LDB(B1, 1, 1); PG8_SCHED; PG8_LDA(At, 1, 0); PG8_STAGE(PG8_SA(0, 1), a2 + hstep, voffA);
            PG8_WAIT_V(8); PG8_WAIT_L(0); PG8_BAR; PG8_MMA(0, 0, At, B0); PG8_MMA(0, 1, At, B1); PG8_BAR; PG8_SCHED;
            PG8_LDA(At, 1, 1); PG8_STAGE(PG8_SB(1, 0), b3, voffB); PG8_STAGE(PG8_SB(1, 1), b3 + hstep, voffB); PG8_STAGE(PG8_SA(1, 0), a3, voffA);
            PG8_WAIT_V(8); PG8_WAIT_L(0); PG8_BAR; PG8_MMA(1, 0, At, B0); PG8_MMA(1, 1, At, B1); PG8_BAR; PG8_SCHED;
            } else {
            PG8_LDB(B0, 0, 0); PG8_SCHED; PG8_LDA(At, 0, 0); PG8_STAGE(PG8_SA(1, 1), a1 + hstep, voffA);
            PG8_WAIT_L(8); PG8_BAR; PG8_WAIT_L(0); PG8_MMA(0, 0, At, B0); PG8_BAR; PG8_SCHED;
            PG8_LDB(B1, 0, 1); PG8_STAGE(PG8_SB(0, 0), b2, voffB);
            PG8_BAR; PG8_WAIT_L(0); PG8_MMA(0, 1, At, B1); PG8_BAR;
            PG8_LDA(At, 0, 1); PG8_STAGE(PG8_SA(0, 0), a2, voffA);
            PG8_BAR; PG8_WAIT_L(0); PG8_MMA(1, 0, At, B0); PG8_BAR; PG8_SCHED;
            PG8_STAGE(PG8_SB(0, 1), b2 + hstep, voffB);
            PG8_WAIT_V(6); PG8_BAR; PG8_MMA(1, 1, At, B1); PG8_BAR;
            PG8_LDB(B0, 1, 0); PG8_SCHED; PG8_LDA(At, 1, 0); PG8_STAGE(PG8_SA(0, 1), a2 + hstep, voffA);
            PG8_WAIT_L(8); PG8_BAR; PG8_WAIT_L(0); PG8_MMA(0, 0, At, B0); PG8_BAR; PG8_SCHED;
            PG8_LDB(B1, 1, 1); PG8_STAGE(PG8_SB(1, 0), b3, voffB);
            PG8_BAR; PG8_WAIT_L(0); PG8_MMA(0, 1, At, B1); PG8_BAR;
            PG8_LDA(At, 1, 1); PG8_STAGE(PG8_SA(1, 0), a3, voffA);
            PG8_BAR; PG8_WAIT_L(0); PG8_MMA(1, 0, At, B0); PG8_BAR; PG8_SCHED;
            PG8_STAGE(PG8_SB(1, 1), b3 + hstep, voffB);
            PG8_WAIT_V(6); PG8_BAR; PG8_MMA(1, 1, At, B1); PG8_BAR;
            }
        }
        if constexpr (ALIGN_EPI) { if (wr == 0) PG8_BAR; }
        if constexpr (!Epi::AFTER_DRAIN) { E(acc, cur, wr, wc, fr, fq); S.done(cur); }
        if (!has_next) break;
#pragma unroll
        for (int a = 0; a < 2; ++a)
#pragma unroll
            for (int b = 0; b < 2; ++b)
#pragma unroll
                for (int m = 0; m < 4; ++m)
#pragma unroll
                    for (int n = 0; n < 2; ++n) acc[a][b][m][n] = (f32x4){0.f, 0.f, 0.f, 0.f};
        cur = nxt; cA = nA; cB = nB; ++ui;
        if constexpr (ALIGN_EPI) { if (wr == 1) PG8_BAR; }
    }
    PG8_WAIT_V(0);
    if constexpr (!ALIGN_EPI) { if (wr == 0) PG8_BAR; }
    PG8_BAR;
#undef PG8_SA
#undef PG8_SB
#undef PG8_STAGE
#undef PG8_LDA
#undef PG8_LDB
#undef PG8_MMA
#undef PG8_WAIT_V
#undef PG8_WAIT_L
#undef PG8_BAR
#undef PG8_SCHED
}
}

#ifndef PG8_SP2
#define PG8_SP2 true
#endif
#ifndef PG8_ALIGN
#define PG8_ALIGN true
#endif

constexpr int NWAVES = 8;
constexpr int N_LAUNCHES = MK_N_LAUNCHES;
constexpr int N_PHASES = 18;
constexpr int BATCH = 4, SEQ = 8192, D = 1024, FF = 2816, NH = 4, DQK = 128, DV = 256, LCH = 64, NCH = SEQ / LCH;
constexpr int M = BATCH * SEQ;
constexpr int MIN_DIM = 3080;
constexpr int NBH = BATCH * NH, NUNIT = NBH * NCH;
constexpr float EPS = 1e-6f;

constexpr size_t MiB = 1u << 20;
constexpr size_t WS_CTL = 0, CTL_ZERO_BYTES = 64 * 1024;
constexpr size_t WS_SSQ = 1 * MiB;
constexpr size_t WS_GA = 3 * MiB, WS_GB = WS_GA + 512 * 1024, WS_GC = WS_GB + 512 * 1024;
constexpr size_t WS_AMAX = WS_GC + 512 * 1024, WS_BLAST = WS_AMAX + 8192;
constexpr size_t WS_NST = 5 * MiB;
constexpr size_t WS_WG8 = 6 * MiB;
constexpr size_t WS_WGU = 8 * MiB;
constexpr size_t WS_WD = 52 * MiB;
constexpr size_t WS_WCI = 74 * MiB, WS_WCO = 80 * MiB, WS_WMI = 82 * MiB, WS_WMO = 88 * MiB;
constexpr size_t WS_HB = 90 * MiB;
constexpr size_t WS_STATE = 90 * MiB;
constexpr size_t WS_ACT = 218 * MiB;
constexpr size_t WS_MIX = 410 * MiB;
constexpr size_t WS_END = 474 * MiB;
constexpr size_t SZ_WGU = (size_t)2 * FF * D * 2, SZ_WD = (size_t)D * FF * 2;
static_assert(WS_WGU + 4 * SZ_WGU <= WS_WD && WS_WD + 4 * SZ_WD <= WS_WCI && WS_STATE + (size_t)NUNIT * 65536 <= WS_ACT && WS_ACT + (size_t)M * 3072 * 2 <= WS_MIX && WS_MIX + (size_t)M * D * 2 <= WS_END, "d_ws map");
constexpr int CW_BAR = 1024;

constexpr int RING_OFF = 0, RING_BYTES = 131072;
constexpr int RSTD_OFF = RING_BYTES;
constexpr int MISC_OFF = RSTD_OFF + 4096;
constexpr int LDS_BYTES = 147456;

#define GAS __attribute__((address_space(1)))
#define LAS __attribute__((address_space(3)))
typedef unsigned short bf16;
typedef unsigned v4u __attribute__((ext_vector_type(4)));
typedef unsigned v2u __attribute__((ext_vector_type(2)));
typedef float f32x4 __attribute__((ext_vector_type(4)));
typedef short bf16x8 __attribute__((ext_vector_type(8)));
typedef short v4s __attribute__((ext_vector_type(4)));
typedef GAS unsigned gu32;
#define RLX_AGENT __ATOMIC_RELAXED, __HIP_MEMORY_SCOPE_AGENT
#define LDS_WAIT() asm volatile("s_waitcnt lgkmcnt(0)" ::: "memory")
__device__ __forceinline__ unsigned f2bf(float f) { unsigned u = __builtin_bit_cast(unsigned, f); return (u + 0x7fffu + ((u >> 16) & 1u)) >> 16; }
__device__ __forceinline__ unsigned pk2(float lo, float hi) { return f2bf(lo) | (f2bf(hi) << 16); }
__device__ __forceinline__ float bflo(unsigned w) { return __builtin_bit_cast(float, w << 16); }
__device__ __forceinline__ float bfhi(unsigned w) { return __builtin_bit_cast(float, w & 0xffff0000u); }

#define XB_TMO      128
#define XB_XCNT(j)  (256  + 64 * (j))
#define XB_XSUB(j)  (1280 + 64 * (j))
#define XB_XGEN(j)  (2304 + 64 * (j))
#define XB_TOP      3328
#define XB_TOPGEN   3392
#define XCD_BAR_WORDS 3456
#define XB_SPIN_CAP (1u << 18)

__device__ __forceinline__ unsigned xb_ld(unsigned* p)              { return __hip_atomic_load(p, __ATOMIC_RELAXED, __HIP_MEMORY_SCOPE_AGENT); }
__device__ __forceinline__ unsigned xb_add(unsigned* p, unsigned v) { return __hip_atomic_fetch_add(p, v, __ATOMIC_RELAXED, __HIP_MEMORY_SCOPE_AGENT); }
__device__ __forceinline__ unsigned xb_xcc_id() { return (unsigned)__builtin_amdgcn_s_getreg((3 << 11) | 20) & 0xFu; }
#define XB_SPIN(cond, bar) do { unsigned _sp = 0; while (cond) { __builtin_amdgcn_s_sleep(1); \
    if ((++_sp & 255u) == 0u) { if (xb_ld(&(bar)[XB_TMO])) break; if (_sp > XB_SPIN_CAP) { atomicAdd(&(bar)[XB_TMO], 1u); break; } } } } while (0)

struct XcdBarrier {
    unsigned* bar; unsigned x;
    volatile LAS unsigned* st;
};
__device__ __forceinline__ XcdBarrier xcd_barrier_post(unsigned* bar, volatile LAS unsigned* st) {
    XcdBarrier b; b.bar = bar; b.x = xb_xcc_id(); b.st = st;
    if (threadIdx.x == 0) (void)xb_add(&bar[XB_XCNT(b.x)], 1u);
    return b;
}
__device__ __forceinline__ void xcd_barrier_complete(unsigned* bar, unsigned x, unsigned& nloc, unsigned& nx) {
    const unsigned G = gridDim.x * gridDim.y * gridDim.z;
    unsigned sum, cnt, mine, sp = 0u;
    for (;;) {
        sum = 0u; cnt = 0u; mine = 0u;
#pragma unroll
        for (unsigned j = 0; j < 16; ++j) { const unsigned c = xb_ld(&bar[XB_XCNT(j)]); sum += c; cnt += (c > 0u) ? 1u : 0u; mine = (j == x) ? c : mine; }
        if (sum == G) break;
        __builtin_amdgcn_s_sleep(1);
        if ((++sp & 255u) == 0u) { if (xb_ld(&bar[XB_TMO])) break; if (sp > XB_SPIN_CAP) { atomicAdd(&bar[XB_TMO], 1u); break; } }
    }
    nloc = mine > 0u ? mine : 1u; nx = cnt > 0u ? cnt : 1u;
}
__device__ __forceinline__ void xcd_barrier(const XcdBarrier& b) {
    asm volatile("s_waitcnt vmcnt(0)" ::: "memory");
    __syncthreads();
    if (threadIdx.x == 0) {
        unsigned* bar = b.bar;
        __builtin_amdgcn_s_waitcnt(0);
        unsigned nloc = b.st[0], nx = b.st[1];
        if (nloc == 0u) { xcd_barrier_complete(bar, b.x, nloc, nx); b.st[0] = nloc; b.st[1] = nx; }
        const unsigned old = xb_add(&bar[XB_XSUB(b.x)], 1u);
        const unsigned gen = old / nloc;
        if (old + 1u == (gen + 1u) * nloc) {
            __builtin_amdgcn_fence(__ATOMIC_RELEASE, "agent");
            asm volatile("s_waitcnt vmcnt(0)" ::: "memory");
            const unsigned og = xb_add(&bar[XB_TOP], 1u);
            const unsigned tg = og / nx;
            if (og + 1u == (tg + 1u) * nx) xb_add(&bar[XB_TOPGEN], 1u);
            else XB_SPIN(xb_ld(&bar[XB_TOPGEN]) == tg, bar);
            __builtin_amdgcn_fence(__ATOMIC_ACQUIRE, "agent");
            xb_add(&bar[XB_XGEN(b.x)], 1u);
            asm volatile("s_waitcnt vmcnt(0)" ::: "memory");
        } else {
            XB_SPIN(xb_ld(&bar[XB_XGEN(b.x)]) == gen, bar);
            __builtin_amdgcn_fence(__ATOMIC_ACQUIRE, "agent");
            asm volatile("s_waitcnt vmcnt(0)" ::: "memory");
        }
    }
    __syncthreads();
}

__device__ __forceinline__ float wave_sum(float v) {
#pragma unroll
    for (int o = 1; o < 64; o <<= 1) v += __shfl_xor(v, o);
    return v;
}
__device__ __forceinline__ unsigned off_b(unsigned row, unsigned ch) { return 256u * row + 16u * (ch ^ (((row & 3) << 2) | ((row >> 2) & 3))); }
__device__ __forceinline__ unsigned row_read_addr_16(unsigned lane, unsigned rb, unsigned s) { return off_b((lane & 15) + 16 * rb, 4 * s + (lane >> 4)); }
__device__ __forceinline__ unsigned tr_read_addr_16(unsigned lane, unsigned c, unsigned ks, unsigned t) {
    const unsigned g = lane >> 4, q = (lane & 15) >> 2, p = lane & 3;
    return off_b(32 * ks + 8 * g + 4 * t + q, 2 * c + (p >> 1)) + 8 * (p & 1);
}
__device__ __forceinline__ bf16x8 tr_frag(LAS unsigned char* img, unsigned lane, unsigned c, unsigned ks) {
    const v4s lo = __builtin_amdgcn_ds_read_tr16_b64_v4i16((LAS v4s*)(img + tr_read_addr_16(lane, c, ks, 0)));
    const v4s hi = __builtin_amdgcn_ds_read_tr16_b64_v4i16((LAS v4s*)(img + tr_read_addr_16(lane, c, ks, 1)));
    return __builtin_shufflevector(lo, hi, 0, 1, 2, 3, 4, 5, 6, 7);
}
__device__ __forceinline__ bf16x8 row_frag(LAS unsigned char* img, unsigned lane, unsigned rb, unsigned s) { return *(const LAS bf16x8*)(img + row_read_addr_16(lane, rb, s)); }

__device__ __forceinline__ void mscan(const float* amax, const float* blast, int lane, float& mp0, float& mp1) {
    const float a0 = amax[2 * lane], a1 = amax[2 * lane + 1], b0 = blast[2 * lane], b1 = blast[2 * lane + 1];
    const float p0 = b0, r0 = a0 + b0, p1 = b1, r1 = a1 + b1;
    float P = p0 + p1, R = fmaxf(r0 + p1, r1);
#pragma unroll
    for (int d = 1; d < 64; d <<= 1) { const float Po = __shfl_up(P, d), Ro = __shfl_up(R, d); if (lane >= d) { R = fmaxf(Ro + P, R); P = Po + P; } }
    float Pe = __shfl_up(P, 1), Re = __shfl_up(R, 1); if (lane == 0) { Pe = 0.f; Re = -INFINITY; }
    mp0 = fmaxf(Pe, Re); mp1 = fmaxf(mp0 + p0, r0);
}
__device__ __forceinline__ float mscan_at(const float* amax, const float* blast, int lane, int j) {
    float mp0, mp1; mscan(amax, blast, lane, mp0, mp1);
    const float lo = __shfl(mp0, j >> 1), hi = __shfl(mp1, j >> 1);
    return (j & 1) ? hi : lo;
}

struct Args {
    const float *x, *norm_g, *w_gate, *w_up, *w_down, *conv_w_in, *conv_w, *conv_w_out, *ml_w_in, *ml_b_gates, *ml_head_norm, *ml_w_out, *final_g;
    float* out; unsigned char* ws; int ph_lo, ph_hi;
};

__device__ __forceinline__ void transpose_item(const float* Wc, int ld, const float* gk, float scale, bf16* WTr, int K, int k0, LAS float* scr, int lane) {
#pragma unroll 8
    for (int i = 0; i < 32; ++i) { const int kk = 2 * i + (lane >> 5); float v = Wc[(size_t)(k0 + kk) * ld + (lane & 31)] * scale; if (gk) v *= gk[k0 + kk]; scr[kk * 33 + (lane & 31)] = v; }
    LDS_WAIT(); asm volatile("" ::: "memory");
    const int c = lane & 7;
#pragma unroll
    for (int j = 0; j < 4; ++j) { const int n = (lane >> 3) + 8 * j; const LAS float* s = scr + (8 * c) * 33 + n;
        v4u o; o.x = pk2(s[0 * 33], s[1 * 33]); o.y = pk2(s[2 * 33], s[3 * 33]); o.z = pk2(s[4 * 33], s[5 * 33]); o.w = pk2(s[6 * 33], s[7 * 33]);
        *(GAS v4u*)(WTr + (size_t)n * K + k0 + 8 * c) = o; }
    LDS_WAIT(); asm volatile("" ::: "memory");
}

__device__ __forceinline__ void p_prologue(const Args& a, LAS unsigned char* lds, int wave, int lane) {
    LAS float* scr = (LAS float*)(lds + RING_OFF + wave * 16384);
    const int G = gridDim.x, gw = wave * G + blockIdx.x, NGW = G * NWAVES;
    unsigned char* ws = a.ws;
    constexpr int I_GU = (D / 64) * (2 * FF / 32), I_D = (FF / 64) * (D / 32), I_CI = (D / 64) * (3072 / 32), I_SQ = (D / 64) * (D / 32);
    constexpr int NITEMS = 4 * I_GU + 4 * I_D + 2 * I_CI + 2 * I_SQ;
    for (int it = gw; it < NITEMS; it += NGW) {
        int r = it;
        if (r < 4 * I_GU) {
            const int lf = r / I_GU; r -= lf * I_GU; const int nblk = 2 * FF / 32, kb = r / nblk, nb = r % nblk, d0 = 32 * nb;
            const int pn = d0 >> 8, bj = (d0 >> 7) & 1, rr = d0 & 127;
            const float* src = (bj ? a.w_up : a.w_gate) + (size_t)lf * D * FF + 128 * pn + rr;
            const float* gk = a.norm_g + ((lf >> 1) * 3 + ((lf & 1) ? 2 : 0)) * D;
            transpose_item(src, FF, gk, 1.f, (bf16*)(ws + WS_WGU + (size_t)lf * SZ_WGU) + (size_t)d0 * D, D, 64 * kb, scr, lane); continue; }
        r -= 4 * I_GU;
        if (r < 4 * I_D) {
            const int lf = r / I_D; r -= lf * I_D; const int nblk = D / 32, kb = r / nblk, nb = r % nblk, d0 = 32 * nb;
            transpose_item(a.w_down + (size_t)lf * FF * D + d0, D, nullptr, 1.f, (bf16*)(ws + WS_WD + (size_t)lf * SZ_WD) + (size_t)d0 * FF, FF, 64 * kb, scr, lane); continue; }
        r -= 4 * I_D;
        if (r < I_CI) {
            const int nblk = 3072 / 32, kb = r / nblk, nb = r % nblk, d0 = 32 * nb; const int pn = d0 >> 8;
            int col; if (pn < 8) { const int bj = (d0 >> 7) & 1, rr = d0 & 127; col = (bj ? 2048 : 1024) + 128 * pn + rr; } else col = d0 - 2048;
            transpose_item(a.conv_w_in + col, 3072, a.norm_g + 1 * D, 1.f, (bf16*)(ws + WS_WCI) + (size_t)d0 * D, D, 64 * kb, scr, lane); continue; }
        r -= I_CI;
        if (r < I_CI) {
            const int nblk = 3072 / 32, kb = r / nblk, nb = r % nblk, d0 = 32 * nb;
            const float sc = (d0 >= 512 && d0 < 1024) ? 0.08838834764831845f : 1.f;
            transpose_item(a.ml_w_in + d0, MIN_DIM, a.norm_g + (3 + 1) * D, sc, (bf16*)(ws + WS_WMI) + (size_t)d0 * D, D, 64 * kb, scr, lane); continue; }
        r -= I_CI;
        if (r < I_SQ) { const int nblk = D / 32, kb = r / nblk, nb = r % nblk, d0 = 32 * nb;
            transpose_item(a.conv_w_out + d0, D, nullptr, 1.f, (bf16*)(ws + WS_WCO) + (size_t)d0 * D, D, 64 * kb, scr, lane); continue; }
        r -= I_SQ;
        { const int nblk = D / 32, kb = r / nblk, nb = r % nblk, d0 = 32 * nb;
            transpose_item(a.ml_w_out + d0, D, a.ml_head_norm, 1.f, (bf16*)(ws + WS_WMO) + (size_t)d0 * D, D, 64 * kb, scr, lane); }
    }
    { bf16* wg8 = (bf16*)(ws + WS_WG8); const float* gk = a.norm_g + 4 * D;
      for (int i = blockIdx.x * 512 + threadIdx.x; i < 16 * D; i += G * 512) { const int c = i >> 10, k = i & 1023; wg8[i] = (bf16)(c < 8 ? f2bf(a.ml_w_in[(size_t)k * MIN_DIM + 3072 + c] * gk[k]) : 0u); } }
    bf16* hb = (bf16*)(ws + WS_HB); float* ssq = (float*)(ws + WS_SSQ);
    for (int m = gw; m < M; m += NGW) {
        const GAS f32x4* xr = (const GAS f32x4*)(a.x + (size_t)m * D) + lane; f32x4 v[4]; float s = 0.f;
#pragma unroll
        for (int j = 0; j < 4; ++j) { v[j] = xr[64 * j]; s += (v[j].x * v[j].x + v[j].y * v[j].y) + (v[j].z * v[j].z + v[j].w * v[j].w); }
        s = wave_sum(s);
        GAS unsigned long long* o8 = (GAS unsigned long long*)(hb + (size_t)m * D) + lane;
#pragma unroll
        for (int j = 0; j < 4; ++j) o8[64 * j] = (unsigned long long)pk2(v[j].x, v[j].y) | ((unsigned long long)pk2(v[j].z, v[j].w) << 32);
        if (lane < 16) ssq[(size_t)m * 16 + lane] = (lane == 0) ? s : 0.f;
    }
}

__device__ __forceinline__ pg8::RstdTab build_rstd(const pg8::StaticOrder& S, const float* ssq, LAS unsigned char* lds) {
    pg8::RstdTab rt; rt.p0 = rt.p1 = rt.p2 = rt.p3 = -1; rt.tab = (const LAS float*)(lds + RSTD_OFF);
    int np = 0; pg8::Unit u;
    for (int i = 0; S.next(i, u); ++i) {
        const int pm = u.pm;
        if (pm == rt.p0 || pm == rt.p1 || pm == rt.p2 || pm == rt.p3) continue;
        if (np == 0) rt.p0 = pm; else if (np == 1) rt.p1 = pm; else if (np == 2) rt.p2 = pm; else rt.p3 = pm;
        ++np;
    }
    LAS float* tab = (LAS float*)(lds + RSTD_OFF);
    for (int idx = threadIdx.x; idx < 1024; idx += 512) {
        const int s = idx >> 8, pm = (s == 0) ? rt.p0 : (s == 1) ? rt.p1 : (s == 2) ? rt.p2 : rt.p3;
        float r = 0.f;
        if (pm >= 0) { const f32x4* p = (const f32x4*)(ssq + (size_t)(pm * 256 + (idx & 255)) * 16); const f32x4 a0 = p[0], a1 = p[1], a2 = p[2], a3 = p[3];
            const float t = ((a0.x + a0.y) + (a0.z + a0.w)) + ((a1.x + a1.y) + (a1.z + a1.w)) + ((a2.x + a2.y) + (a2.z + a2.w)) + ((a3.x + a3.y) + (a3.z + a3.w));
            r = 1.0f / sqrtf(t * (1.0f / D) + EPS); }
        tab[idx] = r;
    }
    __syncthreads();
    return rt;
}

__device__ __forceinline__ void p_conv_thin(const Args& a) {
    const bf16* U = (const bf16*)(a.ws + WS_ACT); const bf16* GBt = U + (size_t)M * D; bf16* MIX = (bf16*)(a.ws + WS_MIX);
    const int T = blockIdx.x * 512 + threadIdx.x, NT = gridDim.x * 512;
    for (int it = T; it < (M / 16) * 128; it += NT) {
        const int ch = it & 127, row0 = (it >> 7) * 16;
        float w0[8], w1[8], w2[8];
#pragma unroll
        for (int j = 0; j < 8; ++j) { w0[j] = a.conv_w[0 * D + ch * 8 + j]; w1[j] = a.conv_w[1 * D + ch * 8 + j]; w2[j] = a.conv_w[2 * D + ch * 8 + j]; }
        float um2[8], um1[8];
        if ((row0 & (SEQ - 1)) != 0) {
            const v4u p2 = *(const v4u*)(U + (size_t)(row0 - 2) * D + ch * 8), p1 = *(const v4u*)(U + (size_t)(row0 - 1) * D + ch * 8);
            um2[0] = bflo(p2.x); um2[1] = bfhi(p2.x); um2[2] = bflo(p2.y); um2[3] = bfhi(p2.y); um2[4] = bflo(p2.z); um2[5] = bfhi(p2.z); um2[6] = bflo(p2.w); um2[7] = bfhi(p2.w);
            um1[0] = bflo(p1.x); um1[1] = bfhi(p1.x); um1[2] = bflo(p1.y); um1[3] = bfhi(p1.y); um1[4] = bflo(p1.z); um1[5] = bfhi(p1.z); um1[6] = bflo(p1.w); um1[7] = bfhi(p1.w);
        } else {
#pragma unroll
            for (int j = 0; j < 8; ++j) { um2[j] = 0.f; um1[j] = 0.f; }
        }
#pragma unroll 4
        for (int r = 0; r < 16; ++r) {
            const size_t o = (size_t)(row0 + r) * D + ch * 8;
            const v4u pu = *(const v4u*)(U + o), pg = *(const v4u*)(GBt + o);
            float uc[8], gb[8], ov[8];
            uc[0] = bflo(pu.x); uc[1] = bfhi(pu.x); uc[2] = bflo(pu.y); uc[3] = bfhi(pu.y); uc[4] = bflo(pu.z); uc[5] = bfhi(pu.z); uc[6] = bflo(pu.w); uc[7] = bfhi(pu.w);
            gb[0] = bflo(pg.x); gb[1] = bfhi(pg.x); gb[2] = bflo(pg.y); gb[3] = bfhi(pg.y); gb[4] = bflo(pg.z); gb[5] = bfhi(pg.z); gb[6] = bflo(pg.w); gb[7] = bfhi(pg.w);
#pragma unroll
            for (int j = 0; j < 8; ++j) { ov[j] = gb[j] * (w0[j] * um2[j] + w1[j] * um1[j] + w2[j] * uc[j]); um2[j] = um1[j]; um1[j] = uc[j]; }
            v4u w; w.x = pk2(ov[0], ov[1]); w.y = pk2(ov[2], ov[3]); w.z = pk2(ov[4], ov[5]); w.w = pk2(ov[6], ov[7]);
            *(v4u*)(MIX + o) = w;
        }
    }
}

__device__ __forceinline__ float logsigmoid_f(float x) { return fminf(x, 0.f) - log1pf(expf(-fabsf(x))); }
__device__ __forceinline__ void p_gates(const Args& a, int wave, int lane) {
    const bf16* hb = (const bf16*)(a.ws + WS_HB); const bf16* wg8 = (const bf16*)(a.ws + WS_WG8); const float* ssq = (const float*)(a.ws + WS_SSQ);
    float* GA = (float*)(a.ws + WS_GA); float* GBc = (float*)(a.ws + WS_GB); float* GC = (float*)(a.ws + WS_GC); float* AMAX = (float*)(a.ws + WS_AMAX); float* BLAST = (float*)(a.ws + WS_BLAST);
    const int G = gridDim.x, i = lane & 15, g = lane >> 4;
    for (int job = wave * G + blockIdx.x; job < BATCH * NCH; job += G * NWAVES) {
        const int b = job / NCH, j = job % NCH, row0 = b * SEQ + j * LCH;
        float rstd_t;
        { const f32x4* p = (const f32x4*)(ssq + (size_t)(row0 + lane) * 16); const f32x4 a0 = p[0], a1 = p[1], a2 = p[2], a3 = p[3];
          const float t = ((a0.x + a0.y) + (a0.z + a0.w)) + ((a1.x + a1.y) + (a1.z + a1.w)) + ((a2.x + a2.y) + (a2.z + a2.w)) + ((a3.x + a3.y) + (a3.z + a3.w));
          rstd_t = 1.0f / sqrtf(t * (1.0f / D) + EPS); }
        f32x4 acc[4];
#pragma unroll
        for (int mb = 0; mb < 4; ++mb) acc[mb] = (f32x4){0.f, 0.f, 0.f, 0.f};
#pragma unroll 4
        for (int ks = 0; ks < 32; ++ks) {
            const bf16x8 Bf = *(const bf16x8*)(wg8 + (size_t)i * D + 32 * ks + 8 * g);
#pragma unroll
            for (int mb = 0; mb < 4; ++mb) { const bf16x8 Af = *(const bf16x8*)(hb + (size_t)(row0 + 16 * mb + i) * D + 32 * ks + 8 * g);
                acc[mb] = __builtin_amdgcn_mfma_f32_16x16x32_bf16(Af, Bf, acc[mb], 0, 0, 0); }
        }
        const float bias = (i < 8) ? a.ml_b_gates[i] : 0.f;
        float val[16];
#pragma unroll
        for (int mb = 0; mb < 4; ++mb)
#pragma unroll
            for (int r = 0; r < 4; ++r) { const float rs = __shfl(rstd_t, 16 * mb + 4 * g + r); float v = acc[mb][r] * rs + bias; if (i >= 4) v = logsigmoid_f(v); val[mb * 4 + r] = v; }
        float pre[16], tot[4];
#pragma unroll
        for (int mb = 0; mb < 4; ++mb) { float run = 0.f;
#pragma unroll
            for (int r = 0; r < 4; ++r) { run += val[mb * 4 + r]; pre[mb * 4 + r] = run; } tot[mb] = run; }
        float base = 0.f;
#pragma unroll
        for (int mb = 0; mb < 4; ++mb) { const float t0 = __shfl(tot[mb], i), t1 = __shfl(tot[mb], i + 16), t2 = __shfl(tot[mb], i + 32), t3 = __shfl(tot[mb], i + 48);
            const float off = base + (g > 0 ? t0 : 0.f) + (g > 1 ? t1 : 0.f) + (g > 2 ? t2 : 0.f);
#pragma unroll
            for (int r = 0; r < 4; ++r) pre[mb * 4 + r] += off;
            base += (t0 + t1) + (t2 + t3); }
        float bc[16], av[16], cm[16];
#pragma unroll
        for (int k = 0; k < 16; ++k) { bc[k] = __shfl(pre[k], (lane + 4) & 63); av[k] = val[k] - bc[k]; }
        const float blast = __shfl(base, (lane + 4) & 63);
        float mt[4];
#pragma unroll
        for (int mb = 0; mb < 4; ++mb) { float run = -INFINITY;
#pragma unroll
            for (int r = 0; r < 4; ++r) { run = fmaxf(run, av[mb * 4 + r]); cm[mb * 4 + r] = run; } mt[mb] = run; }
        float mbase = -INFINITY;
#pragma unroll
        for (int mb = 0; mb < 4; ++mb) { const float t0 = __shfl(mt[mb], i), t1 = __shfl(mt[mb], i + 16), t2 = __shfl(mt[mb], i + 32), t3 = __shfl(mt[mb], i + 48);
            const float off = fmaxf(fmaxf(mbase, g > 0 ? t0 : -INFINITY), fmaxf(g > 1 ? t1 : -INFINITY, g > 2 ? t2 : -INFINITY));
#pragma unroll
            for (int r = 0; r < 4; ++r) cm[mb * 4 + r] = fmaxf(cm[mb * 4 + r], off);
            mbase = fmaxf(fmaxf(mbase, fmaxf(t0, t1)), fmaxf(t2, t3)); }
        if (i < 4) {
            const int bh = b * NH + i; const size_t o = (size_t)bh * SEQ + j * LCH + 4 * g;
#pragma unroll
            for (int mb = 0; mb < 4; ++mb) {
                *(f32x4*)(GA + o + 16 * mb) = (f32x4){av[mb * 4], av[mb * 4 + 1], av[mb * 4 + 2], av[mb * 4 + 3]};
                *(f32x4*)(GBc + o + 16 * mb) = (f32x4){bc[mb * 4], bc[mb * 4 + 1], bc[mb * 4 + 2], bc[mb * 4 + 3]};
                *(f32x4*)(GC + o + 16 * mb) = (f32x4){cm[mb * 4], cm[mb * 4 + 1], cm[mb * 4 + 2], cm[mb * 4 + 3]};
            }
            if (g == 0) { AMAX[bh * NCH + j] = mbase; BLAST[bh * NCH + j] = blast; }
        }
    }
}

constexpr int ML_Q = 0, ML_K = 16384, ML_V = 32768, ML_P = 65536, ML_H = 77824, ML_S = 114688;
constexpr int P_PITCH = 144, H_PITCH = 528;
__device__ __forceinline__ void stage_tile128(const bf16* src, int ld, LAS unsigned char* img, int tid) {
#pragma unroll
    for (int it = 0; it < 2; ++it) { const int c = tid + 512 * it, r = c >> 4, ch = c & 15; const v4u v = *(const v4u*)(src + (size_t)r * ld + ch * 8); *(LAS v4u*)(img + off_b(r, ch)) = v; }
}
__device__ __forceinline__ void p_mlstm_A(const Args& a, LAS unsigned char* lds, int wave, int lane) {
    const bf16* QKVO = (const bf16*)(a.ws + WS_ACT); unsigned char* STATE = a.ws + WS_STATE; float* NST = (float*)(a.ws + WS_NST);
    const float* GA = (const float*)(a.ws + WS_GA); const float* AMAX = (const float*)(a.ws + WS_AMAX); const float* BLAST = (const float*)(a.ws + WS_BLAST);
    const int tid = threadIdx.x, i = lane & 15, g = lane >> 4;
    LAS float* wL = (LAS float*)(lds + ML_S);
    for (int unit = blockIdx.x; unit < NUNIT; unit += gridDim.x) {
        const int bh = unit >> 7, j = unit & 127, b = bh >> 2, h = bh & 3, row0 = b * SEQ + j * LCH;
        const float mprev = mscan_at(AMAX + bh * NCH, BLAST + bh * NCH, lane, j), Mend = fmaxf(mprev, AMAX[bh * NCH + j]);
        __syncthreads();
        stage_tile128(QKVO + (size_t)row0 * 3072 + 512 + 128 * h, 3072, lds + ML_K, tid);
        if (tid < 64) wL[tid] = expf(GA[(size_t)bh * SEQ + j * LCH + tid] - Mend);
#pragma unroll
        for (int it = 0; it < 4; ++it) { const int c = tid + 512 * it, r = c >> 5, c32 = c & 31;
            const v4u v = *(const v4u*)(QKVO + (size_t)(row0 + r) * 3072 + 1024 + 256 * h + c32 * 8);
            const float w = expf(GA[(size_t)bh * SEQ + j * LCH + r] - Mend);
            v4u o; o.x = pk2(bflo(v.x) * w, bfhi(v.x) * w); o.y = pk2(bflo(v.y) * w, bfhi(v.y) * w); o.z = pk2(bflo(v.z) * w, bfhi(v.z) * w); o.w = pk2(bflo(v.w) * w, bfhi(v.w) * w);
            *(LAS v4u*)(lds + ML_V + (c32 >> 4) * 16384 + off_b(r, c32 & 15)) = o; }
        __syncthreads();
        if (tid < 128) { float s = 0.f;
            for (int r = 0; r < 64; ++r) { const unsigned short kv = *(const LAS unsigned short*)(lds + ML_K + off_b(r, tid >> 3) + 2 * (tid & 7)); s += wL[r] * __builtin_bit_cast(float, (unsigned)kv << 16); }
            NST[(size_t)unit * 128 + tid] = s; }
        f32x4 acc[8][2];
#pragma unroll
        for (int mk = 0; mk < 8; ++mk) { acc[mk][0] = (f32x4){0.f, 0.f, 0.f, 0.f}; acc[mk][1] = (f32x4){0.f, 0.f, 0.f, 0.f}; }
#pragma unroll
        for (int ks = 0; ks < 2; ++ks) {
            bf16x8 Bf[2];
#pragma unroll
            for (int n2 = 0; n2 < 2; ++n2) { const int nbg = 2 * wave + n2; Bf[n2] = tr_frag(lds + ML_V + (nbg >> 3) * 16384, lane, nbg & 7, ks); }
#pragma unroll
            for (int mk = 0; mk < 8; ++mk) { const bf16x8 Af = tr_frag(lds + ML_K, lane, mk, ks);
                acc[mk][0] = __builtin_amdgcn_mfma_f32_16x16x32_bf16(Af, Bf[0], acc[mk][0], 0, 0, 0);
                acc[mk][1] = __builtin_amdgcn_mfma_f32_16x16x32_bf16(Af, Bf[1], acc[mk][1], 0, 0, 0); }
        }
        unsigned char* st = STATE + (size_t)unit * 65536;
#pragma unroll
        for (int mk = 0; mk < 8; ++mk)
#pragma unroll
            for (int n2 = 0; n2 < 2; ++n2) { const int nbg = 2 * wave + n2, ks2 = mk >> 1, gp = 2 * (mk & 1) + (g >> 1);
                v2u o; o.x = pk2(acc[mk][n2][0], acc[mk][n2][1]); o.y = pk2(acc[mk][n2][2], acc[mk][n2][3]);
                *(v2u*)(st + (size_t)(((nbg * 4 + ks2) * 64 + gp * 16 + i) * 16 + 8 * (g & 1))) = o; }
    }
}

__device__ __forceinline__ void p_mlstm_B(const Args& a, LAS unsigned char* lds, int wave, int lane) {
    unsigned char* STATE = a.ws + WS_STATE; float* NST = (float*)(a.ws + WS_NST);
    const float* AMAX = (const float*)(a.ws + WS_AMAX); const float* BLAST = (const float*)(a.ws + WS_BLAST);
    const int tid = threadIdx.x;
    LAS float* decL = (LAS float*)(lds + ML_S);
    for (int item = blockIdx.x; item < NBH * 16; item += gridDim.x) {
        const int bh = item >> 4, part = item & 15;
        __syncthreads();
        if (wave == 0) { float mp0, mp1; mscan(AMAX + bh * NCH, BLAST + bh * NCH, lane, mp0, mp1);
            decL[2 * lane] = expf(mp0 - fmaxf(mp0, AMAX[bh * NCH + 2 * lane])); decL[2 * lane + 1] = expf(mp1 - fmaxf(mp1, AMAX[bh * NCH + 2 * lane + 1])); }
        __syncthreads();
        unsigned char* p = STATE + (size_t)bh * NCH * 65536 + (size_t)(part * 512 + tid) * 8;
        float c0 = 0.f, c1 = 0.f, c2 = 0.f, c3 = 0.f;
        for (int j0 = 0; j0 < NCH; j0 += 8) {
            v2u u[8];
#pragma unroll
            for (int jj = 0; jj < 8; ++jj) u[jj] = *(const v2u*)(p + (size_t)(j0 + jj) * 65536);
#pragma unroll
            for (int jj = 0; jj < 8; ++jj) {
                v2u o; o.x = pk2(c0, c1); o.y = pk2(c2, c3); *(v2u*)(p + (size_t)(j0 + jj) * 65536) = o;
                const float d = decL[j0 + jj];
                c0 = d * c0 + bflo(u[jj].x); c1 = d * c1 + bfhi(u[jj].x); c2 = d * c2 + bflo(u[jj].y); c3 = d * c3 + bfhi(u[jj].y);
            }
        }
        if (part == 0 && tid < 128) { float* q = NST + (size_t)bh * NCH * 128 + tid; float n = 0.f;
            for (int j = 0; j < NCH; ++j) { const float u = q[(size_t)j * 128]; q[(size_t)j * 128] = n; n = decL[j] * n + u; } }
    }
}

__device__ __forceinline__ float sigmoid_f(float x) { return __builtin_amdgcn_rcpf(1.0f + __builtin_amdgcn_exp2f(-1.44269504089f * x)); }
__device__ __forceinline__ void p_mlstm_C(const Args& a, LAS unsigned char* lds, int wave, int lane) {
    const bf16* QKVO = (const bf16*)(a.ws + WS_ACT); const unsigned char* STATE = a.ws + WS_STATE; const float* NST = (const float*)(a.ws + WS_NST);
    const float* GA = (const float*)(a.ws + WS_GA); const float* GBc = (const float*)(a.ws + WS_GB); const float* GC = (const float*)(a.ws + WS_GC);
    const float* AMAX = (const float*)(a.ws + WS_AMAX); const float* BLAST = (const float*)(a.ws + WS_BLAST);
    bf16* MIX = (bf16*)(a.ws + WS_MIX);
    const int tid = threadIdx.x, i = lane & 15, g = lane >> 4;
    LAS float* aL = (LAS float*)(lds + ML_S); LAS float* bcL = aL + 64; LAS float* ML_ = aL + 128; LAS float* qnL = aL + 192; LAS float* nL = aL + 256; LAS float* rsL = aL + 384; LAS float* ssL = aL + 512;
    for (int unit = blockIdx.x; unit < NUNIT; unit += gridDim.x) {
        const int bh = unit >> 7, j = unit & 127, b = bh >> 2, h = bh & 3, row0 = b * SEQ + j * LCH;
        const float mprev = mscan_at(AMAX + bh * NCH, BLAST + bh * NCH, lane, j);
        __syncthreads();
        stage_tile128(QKVO + (size_t)row0 * 3072 + 128 * h, 3072, lds + ML_Q, tid);
        stage_tile128(QKVO + (size_t)row0 * 3072 + 512 + 128 * h, 3072, lds + ML_K, tid);
#pragma unroll
        for (int it = 0; it < 4; ++it) { const int c = tid + 512 * it, r = c >> 5, c32 = c & 31;
            const v4u v = *(const v4u*)(QKVO + (size_t)(row0 + r) * 3072 + 1024 + 256 * h + c32 * 8);
            *(LAS v4u*)(lds + ML_V + (c32 >> 4) * 16384 + off_b(r, c32 & 15)) = v; }
        if (tid < 64) { const size_t o = (size_t)bh * SEQ + j * LCH + tid; aL[tid] = GA[o]; bcL[tid] = GBc[o]; ML_[tid] = fmaxf(mprev, GC[o]); }
        else if (tid < 192) nL[tid - 64] = NST[(size_t)unit * 128 + (tid - 64)];
        __syncthreads();
        { const int q = tid >> 3, part = tid & 7; float s = 0.f;
          const v4u q0 = *(const LAS v4u*)(lds + ML_Q + off_b(q, 2 * part)), q1 = *(const LAS v4u*)(lds + ML_Q + off_b(q, 2 * part + 1)); const LAS float* np = nL + 16 * part;
          s += bflo(q0.x) * np[0] + bfhi(q0.x) * np[1] + bflo(q0.y) * np[2] + bfhi(q0.y) * np[3] + bflo(q0.z) * np[4] + bfhi(q0.z) * np[5] + bflo(q0.w) * np[6] + bfhi(q0.w) * np[7];
          s += bflo(q1.x) * np[8] + bfhi(q1.x) * np[9] + bflo(q1.y) * np[10] + bfhi(q1.y) * np[11] + bflo(q1.z) * np[12] + bfhi(q1.z) * np[13] + bflo(q1.w) * np[14] + bfhi(q1.w) * np[15];
          s += __shfl_xor(s, 1); s += __shfl_xor(s, 2); s += __shfl_xor(s, 4);
          if (part == 0) qnL[q] = s; }
        { const int qb = wave & 3, q = 16 * qb + i; const float Mq = ML_[q]; float rowsum = 0.f;
#pragma unroll
          for (int s2 = 0; s2 < 2; ++s2) { const int sb = 2 * (wave >> 2) + s2;
              f32x4 sacc = (f32x4){0.f, 0.f, 0.f, 0.f};
              if (sb <= qb) {
#pragma unroll
                  for (int ks = 0; ks < 4; ++ks) { const bf16x8 Af = row_frag(lds + ML_K, lane, sb, ks), Bf = row_frag(lds + ML_Q, lane, qb, ks);
                      sacc = __builtin_amdgcn_mfma_f32_16x16x32_bf16(Af, Bf, sacc, 0, 0, 0); } }
              float pv[4];
#pragma unroll
              for (int r = 0; r < 4; ++r) { const int s = 16 * sb + 4 * g + r; pv[r] = (s <= q) ? sacc[r] * expf(aL[s] - Mq) : 0.f; rowsum += pv[r]; }
              v2u o; o.x = pk2(pv[0], pv[1]); o.y = pk2(pv[2], pv[3]);
              *(LAS v2u*)(lds + ML_P + q * P_PITCH + (16 * sb + 4 * g) * 2) = o; }
          rowsum += __shfl_xor(rowsum, 16); rowsum += __shfl_xor(rowsum, 32);
          if (g == 0) rsL[(wave >> 2) * 64 + q] = rowsum; }
        __syncthreads();
        f32x4 acc1[2][4], acc2[2][4];
#pragma unroll
        for (int m2 = 0; m2 < 2; ++m2)
#pragma unroll
            for (int qb = 0; qb < 4; ++qb) { acc1[m2][qb] = (f32x4){0.f, 0.f, 0.f, 0.f}; acc2[m2][qb] = (f32x4){0.f, 0.f, 0.f, 0.f}; }
#pragma unroll
        for (int ks = 0; ks < 2; ++ks) {
            bf16x8 Bp[4];
#pragma unroll
            for (int qb = 0; qb < 4; ++qb) Bp[qb] = *(const LAS bf16x8*)(lds + ML_P + (16 * qb + i) * P_PITCH + (32 * ks + 8 * g) * 2);
#pragma unroll
            for (int m2 = 0; m2 < 2; ++m2) { const int nbg = 2 * wave + m2; const bf16x8 Af = tr_frag(lds + ML_V + (nbg >> 3) * 16384, lane, nbg & 7, ks);
#pragma unroll
                for (int qb = 0; qb < 4; ++qb) acc1[m2][qb] = __builtin_amdgcn_mfma_f32_16x16x32_bf16(Af, Bp[qb], acc1[m2][qb], 0, 0, 0); }
        }
        const unsigned char* st = STATE + (size_t)unit * 65536;
#pragma unroll
        for (int ks = 0; ks < 4; ++ks) {
            bf16x8 Bq[4];
#pragma unroll
            for (int qb = 0; qb < 4; ++qb) Bq[qb] = row_frag(lds + ML_Q, lane, qb, ks);
#pragma unroll
            for (int m2 = 0; m2 < 2; ++m2) { const int nbg = 2 * wave + m2; const bf16x8 Af = *(const bf16x8*)(st + (size_t)((nbg * 4 + ks) * 64 + lane) * 16);
#pragma unroll
                for (int qb = 0; qb < 4; ++qb) acc2[m2][qb] = __builtin_amdgcn_mfma_f32_16x16x32_bf16(Af, Bq[qb], acc2[m2][qb], 0, 0, 0); }
        }
#pragma unroll
        for (int qb = 0; qb < 4; ++qb) { const int q = 16 * qb + i; const float Mq = ML_[q], winter = expf(mprev - Mq);
            const float den = rsL[q] + rsL[64 + q] + winter * qnL[q]; const float inv = 1.0f / fmaxf(fabsf(den), expf(-(bcL[q] + Mq))); float ss = 0.f;
#pragma unroll
            for (int m2 = 0; m2 < 2; ++m2)
#pragma unroll
                for (int r = 0; r < 4; ++r) { const float hv = (acc1[m2][qb][r] + winter * acc2[m2][qb][r]) * inv; acc1[m2][qb][r] = hv; ss += hv * hv; }
            ss += __shfl_xor(ss, 16); ss += __shfl_xor(ss, 32);
            if (g == 0) ssL[wave * 64 + q] = ss; }
        __syncthreads();
#pragma unroll
        for (int qb = 0; qb < 4; ++qb) { const int q = 16 * qb + i; float t = 0.f;
#pragma unroll
            for (int w = 0; w < 8; ++w) t += ssL[w * 64 + q];
            const float rstd = 1.0f / sqrtf(t * (1.0f / DV) + EPS);
#pragma unroll
            for (int m2 = 0; m2 < 2; ++m2) { v2u o; o.x = pk2(acc1[m2][qb][0] * rstd, acc1[m2][qb][1] * rstd); o.y = pk2(acc1[m2][qb][2] * rstd, acc1[m2][qb][3] * rstd);
                *(LAS v2u*)(lds + ML_H + q * H_PITCH + (32 * wave + 16 * m2 + 4 * g) * 2) = o; } }
        __syncthreads();
#pragma unroll
        for (int it = 0; it < 4; ++it) { const int c = tid + 512 * it, r = c >> 5, ch = c & 31;
            const v4u hv = *(const LAS v4u*)(lds + ML_H + r * H_PITCH + ch * 16);
            const v4u ov = *(const v4u*)(QKVO + (size_t)(row0 + r) * 3072 + 2048 + 256 * h + ch * 8);
            v4u w; w.x = pk2(bflo(hv.x) * sigmoid_f(bflo(ov.x)), bfhi(hv.x) * sigmoid_f(bfhi(ov.x))); w.y = pk2(bflo(hv.y) * sigmoid_f(bflo(ov.y)), bfhi(hv.y) * sigmoid_f(bfhi(ov.y)));
            w.z = pk2(bflo(hv.z) * sigmoid_f(bflo(ov.z)), bfhi(hv.z) * sigmoid_f(bfhi(ov.z))); w.w = pk2(bflo(hv.w) * sigmoid_f(bflo(ov.w)), bfhi(hv.w) * sigmoid_f(bfhi(ov.w)));
            *(v4u*)(MIX + (size_t)(row0 + r) * D + 256 * h + ch * 8) = w; }
    }
}

__device__ __forceinline__ void p_final(const Args& a, int wave, int lane) {
    const int G = gridDim.x, gw = wave * G + blockIdx.x, NGW = G * NWAVES;
    f32x4 gv[4];
#pragma unroll
    for (int j = 0; j < 4; ++j) gv[j] = ((const f32x4*)a.final_g)[lane + 64 * j];
    for (int m = gw; m < M; m += NGW) {
        GAS f32x4* xr = (GAS f32x4*)(a.out + (size_t)m * D) + lane; f32x4 v[4]; float s = 0.f;
#pragma unroll
        for (int j = 0; j < 4; ++j) { v[j] = xr[64 * j]; s += (v[j].x * v[j].x + v[j].y * v[j].y) + (v[j].z * v[j].z + v[j].w * v[j].w); }
        const float rstd = 1.0f / sqrtf(wave_sum(s) * (1.0f / D) + EPS);
#pragma unroll
        for (int j = 0; j < 4; ++j) xr[64 * j] = v[j] * rstd * gv[j];
    }
}

__global__ void __launch_bounds__(NWAVES * 64, 2) trunk_fwd(Args args) {
    extern __shared__ __attribute__((aligned(16))) unsigned char lds_raw[];
    LAS unsigned char* lds = (LAS unsigned char*)lds_raw;
    volatile LAS unsigned* MISC = (volatile LAS unsigned*)(lds + MISC_OFF);
    const int tid = threadIdx.x, lane = tid & 63, wave = __builtin_amdgcn_readfirstlane(tid >> 6), G = gridDim.x;
    unsigned char* ws = args.ws;
    if (tid < 64) MISC[tid] = 0u;
    __syncthreads();
    XcdBarrier bar; bar.bar = (unsigned*)(ws + WS_CTL) + CW_BAR; bar.x = 0; bar.st = nullptr;
    if (N_LAUNCHES == 1) bar = xcd_barrier_post((unsigned*)(ws + WS_CTL) + CW_BAR, MISC + 8);
    const int lo = args.ph_lo, hi = args.ph_hi;
    int pid = 0;
#define IN() (lo <= pid && pid < hi)
#define SEAM() do { if (lo <= pid && pid + 1 < hi) xcd_barrier(bar); ++pid; } while (0)

    float* ssq = (float*)(ws + WS_SSQ); bf16* HB = (bf16*)(ws + WS_HB); bf16* ACT = (bf16*)(ws + WS_ACT); bf16* MIX = (bf16*)(ws + WS_MIX);

    if (IN()) p_prologue(args, lds, wave, lane);
    SEAM();

#define FFN_PHASES(lf) do { \
    if (IN()) { pg8::Gemm g{HB, (const bf16*)(ws + WS_WGU + (size_t)(lf) * SZ_WGU), M, 2 * FF, D}; pg8::StaticOrder S; S.init(M, 2 * FF, G, (int)blockIdx.x); \
        const pg8::RstdTab rt = build_rstd(S, ssq, lds); \
        pg8::EpiGU E{ACT, FF, rt}; \
        pg8::gemm_phase<pg8::EpiGU, pg8::StaticOrder, PG8_ALIGN, PG8_SP2>(lds + RING_OFF, g, S, E); } \
    SEAM(); \
    if (IN()) { pg8::Gemm g{ACT, (const bf16*)(ws + WS_WD + (size_t)(lf) * SZ_WD), M, D, FF}; pg8::StaticOrder S; S.init(M, D, G, (int)blockIdx.x); \
        pg8::EpiRes E{((lf) == 0) ? args.x : (const float*)args.out, args.out, HB, ssq, 0.5f}; \
        pg8::gemm_phase<pg8::EpiRes, pg8::StaticOrder, PG8_ALIGN, PG8_SP2>(lds + RING_OFF, g, S, E); } \
    SEAM(); } while (0)

    FFN_PHASES(0);
    if (IN()) { pg8::Gemm g{HB, (const bf16*)(ws + WS_WCI), M, 3072, D}; pg8::StaticOrder S; S.init(M, 3072, G, (int)blockIdx.x);
        const pg8::RstdTab rt = build_rstd(S, ssq, lds);
        pg8::EpiConvIn E{ACT, ACT + (size_t)M * D, rt};
        pg8::gemm_phase<pg8::EpiConvIn, pg8::StaticOrder, PG8_ALIGN, PG8_SP2>(lds + RING_OFF, g, S, E); }
    SEAM();
    if (IN()) p_conv_thin(args);
    SEAM();
    if (IN()) { pg8::Gemm g{MIX, (const bf16*)(ws + WS_WCO), M, D, D}; pg8::StaticOrder S; S.init(M, D, G, (int)blockIdx.x);
        pg8::EpiRes E{args.out, args.out, HB, ssq, 1.0f};
        pg8::gemm_phase<pg8::EpiRes, pg8::StaticOrder, PG8_ALIGN, PG8_SP2>(lds + RING_OFF, g, S, E); }
    SEAM();
    FFN_PHASES(1);
    FFN_PHASES(2);
    if (IN()) { pg8::Gemm g{HB, (const bf16*)(ws + WS_WMI), M, 3072, D}; pg8::StaticOrder S; S.init(M, 3072, G, (int)blockIdx.x);
        const pg8::RstdTab rt = build_rstd(S, ssq, lds);
        pg8::EpiPlain E{ACT, 3072, rt};
        pg8::gemm_phase<pg8::EpiPlain, pg8::StaticOrder, PG8_ALIGN, PG8_SP2>(lds + RING_OFF, g, S, E);
        p_gates(args, wave, lane); }
    SEAM();
    if (IN()) p_mlstm_A(args, lds, wave, lane);
    SEAM();
    if (IN()) p_mlstm_B(args, lds, wave, lane);
    SEAM();
    if (IN()) p_mlstm_C(args, lds, wave, lane);
    SEAM();
    if (IN()) { pg8::Gemm g{MIX, (const bf16*)(ws + WS_WMO), M, D, D}; pg8::StaticOrder S; S.init(M, D, G, (int)blockIdx.x);
        pg8::EpiRes E{args.out, args.out, HB, ssq, 1.0f};
        pg8::gemm_phase<pg8::EpiRes, pg8::StaticOrder, PG8_ALIGN, PG8_SP2>(lds + RING_OFF, g, S, E); }
    SEAM();
    FFN_PHASES(3);
    if (IN()) p_final(args, wave, lane);
#undef FFN_PHASES
#undef IN
#undef SEAM
}

extern "C" void kernel_launch(void* const* d_in, const int* in_sizes, int n_in, void* d_out, int out_size, void* d_ws, size_t ws_size, hipStream_t stream) {
    static int grid = 0;
    if (grid == 0) {
        if (n_in != 13 || in_sizes[0] != M * D || out_size != M * D || ws_size < WS_END) { fprintf(stderr, "kernel_launch: unexpected shapes / workspace (n_in %d, ws %zu < %zu); nothing launched\n", n_in, ws_size, (size_t)WS_END); grid = -1; return; }
        int dev = 0, cus = 0, per_cu = 0;
        if (hipGetDevice(&dev) != hipSuccess || hipDeviceGetAttribute(&cus, hipDeviceAttributeMultiprocessorCount, dev) != hipSuccess) { grid = -1; return; }
        if (hipFuncSetAttribute((const void*)trunk_fwd, hipFuncAttributeMaxDynamicSharedMemorySize, LDS_BYTES) != hipSuccess) { fprintf(stderr, "kernel_launch: hipFuncSetAttribute failed\n"); grid = -1; return; }
        if (hipOccupancyMaxActiveBlocksPerMultiprocessor(&per_cu, (const void*)trunk_fwd, NWAVES * 64, LDS_BYTES) != hipSuccess || per_cu < 1)
            fprintf(stderr, "kernel_launch: note: occupancy query reports %d workgroups per CU\n", per_cu);
        (void)hipGetLastError();
        grid = cus;
    }
    if (grid < 0) return;
    if (hipMemsetAsync((char*)d_ws + WS_CTL, 0, CTL_ZERO_BYTES, stream) != hipSuccess) return;
    Args a{};
    a.x = (const float*)d_in[0]; a.norm_g = (const float*)d_in[1]; a.w_gate = (const float*)d_in[2]; a.w_up = (const float*)d_in[3]; a.w_down = (const float*)d_in[4];
    a.conv_w_in = (const float*)d_in[5]; a.conv_w = (const float*)d_in[6]; a.conv_w_out = (const float*)d_in[7]; a.ml_w_in = (const float*)d_in[8]; a.ml_b_gates = (const float*)d_in[9];
    a.ml_head_norm = (const float*)d_in[10]; a.ml_w_out = (const float*)d_in[11]; a.final_g = (const float*)d_in[12];
    a.out = (float*)d_out; a.ws = (unsigned char*)d_ws;
    for (int li = 0; li < N_LAUNCHES; ++li) {
        a.ph_lo = (N_LAUNCHES == 1) ? 0 : li; a.ph_hi = (N_LAUNCHES == 1) ? N_PHASES : li + 1;
        hipLaunchKernelGGL(trunk_fwd, dim3(grid), dim3(NWAVES * 64), LDS_BYTES, stream, a);
        if (hipPeekAtLastError() != hipSuccess) { fprintf(stderr, "kernel_launch: launch %d failed\n", li); break; }
    }
}
```
